# Optimizing an MI355X kernel written in HIP

```python
import math
import jax, jax.numpy as jnp
from jax import lax
import numpy as np

D_MODEL = 1024
BATCH = 8
SEQ = 2048
DEPTH = 1

ROPE_THETA = 10000.0
NORM_EPS = 1e-6
NEG_INF = -1e30

MLA_HEADS = 4
MLA_NOPE_DIM = 128
MLA_ROPE_DIM = 64
MLA_V_DIM = 128
MLA_Q_RANK = 256
MLA_KV_RANK = 128
MLA_QK_DIM = MLA_NOPE_DIM + MLA_ROPE_DIM
MLA_WIDTH = MLA_HEADS * MLA_V_DIM
MLA_QUERY_BLOCK = 128

SWA_Q_HEADS = 8
SWA_KV_HEADS = 2
SWA_HEAD_DIM = 64
SWA_WINDOW = 128
SWA_BLOCK = 128
SWA_WIDTH = SWA_Q_HEADS * SWA_HEAD_DIM

MIX_WIDTH = MLA_WIDTH + SWA_WIDTH

IN_SIZES = (
    MLA_Q_RANK,
    MLA_KV_RANK,
    MLA_ROPE_DIM,
    MLA_WIDTH,
    SWA_Q_HEADS * SWA_HEAD_DIM,
    SWA_KV_HEADS * SWA_HEAD_DIM,
    SWA_KV_HEADS * SWA_HEAD_DIM,
    SWA_WIDTH,
)
IN_WIDTH = sum(IN_SIZES)
IN_SPLITS = tuple(int(v) for v in np.cumsum(IN_SIZES)[:-1])

kernel_name = "hymba_mla_swa_sink_gated_block"


def rms_norm(x, g):
    xf = x.astype(jnp.float32)
    y = xf * lax.rsqrt(jnp.mean(xf * xf, axis=-1, keepdims=True) + NORM_EPS)
    return (y * g.astype(jnp.float32)).astype(x.dtype)


def rope_tables(seq, dim):
    pos = jnp.arange(seq, dtype=jnp.float32)
    inv_freq = 1.0 / (ROPE_THETA ** (jnp.arange(0, dim, 2, dtype=jnp.float32) / dim))
    ang = pos[:, None] * inv_freq[None, :]
    return jnp.cos(ang), jnp.sin(ang)


def apply_rope(x, cos, sin):
    half = x.shape[-1] // 2
    shape = (cos.shape[0],) + (1,) * (x.ndim - 3) + (half,)
    c = cos.reshape(shape).astype(x.dtype)
    s = sin.reshape(shape).astype(x.dtype)
    x1, x2 = x[..., :half], x[..., half:]
    return jnp.concatenate([x1 * c - x2 * s, x2 * c + x1 * s], axis=-1)


def mla_attention(q_nope, q_rope, k_nope, k_rope, v):
    B, S, H, _ = q_nope.shape
    nb = S // MLA_QUERY_BLOCK
    scale = 1.0 / math.sqrt(MLA_QK_DIM)
    kpos = jnp.arange(S)

    def one_block(args):
        qn, qr, i = args
        s = (jnp.einsum('bqhd,bkhd->bhqk', qn, k_nope).astype(jnp.float32)
             + jnp.einsum('bqhr,bkr->bhqk', qr, k_rope).astype(jnp.float32)) * scale
        qpos = i * MLA_QUERY_BLOCK + jnp.arange(MLA_QUERY_BLOCK)
        causal = kpos[None, :] <= qpos[:, None]
        s = jnp.where(causal[None, None], s, NEG_INF)
        p = jax.nn.softmax(s, axis=-1).astype(v.dtype)
        return jnp.einsum('bhqk,bkhd->bqhd', p, v)

    qn_b = q_nope.reshape(B, nb, MLA_QUERY_BLOCK, H, MLA_NOPE_DIM).transpose(1, 0, 2, 3, 4)
    qr_b = q_rope.reshape(B, nb, MLA_QUERY_BLOCK, H, MLA_ROPE_DIM).transpose(1, 0, 2, 3, 4)
    out = lax.map(one_block, (qn_b, qr_b, jnp.arange(nb)))
    return out.transpose(1, 0, 2, 3, 4).reshape(B, S, H * MLA_V_DIM)


def sliding_window_sink_attention(q, k, v, sinks):
    B, S, HQ, D = q.shape
    HKV = k.shape[2]
    G = HQ // HKV
    nb = S // SWA_BLOCK
    scale = 1.0 / math.sqrt(D)

    qb = q.reshape(B, nb, SWA_BLOCK, HKV, G, D)

    def with_prev(t):
        tb = t.reshape(B, nb, SWA_BLOCK, HKV, D)
        prev = jnp.pad(tb[:, :-1], ((0, 0), (1, 0), (0, 0), (0, 0), (0, 0)))
        return jnp.concatenate([prev, tb], axis=2)

    kk = with_prev(k)
    vv = with_prev(v)
    s = jnp.einsum('bnqhgd,bnkhd->bnhgqk', qb, kk).astype(jnp.float32) * scale

    qi = jnp.arange(SWA_BLOCK)[:, None]
    ki = jnp.arange(2 * SWA_BLOCK)[None, :]
    rel = qi + SWA_BLOCK - ki
    band = (rel >= 0) & (rel < SWA_WINDOW)
    has_prev = (jnp.arange(nb)[:, None, None] > 0) | (ki >= SWA_BLOCK)[None]
    valid = band[None] & has_prev
    s = jnp.where(valid[None, :, None, None], s, NEG_INF)

    sink = jnp.broadcast_to(
        sinks.astype(jnp.float32).reshape(1, 1, HKV, G, 1, 1), s.shape[:-1] + (1,))
    p = jax.nn.softmax(jnp.concatenate([s, sink], axis=-1), axis=-1)[..., :-1]
    out = jnp.einsum('bnhgqk,bnkhd->bnqhgd', p.astype(v.dtype), vv)
    return out.reshape(B, S, HQ * D)


def hybrid_layer(x, ln_g, w_in, q_a_g, w_q_up, kv_a_g, w_kv_up, sinks, w_out,
                 cos_mla, sin_mla, cos_swa, sin_swa):
    B, S, _ = x.shape
    h = rms_norm(x, ln_g)
    proj = h @ w_in
    c_q, c_kv, k_rope, g_mla, q_s, k_s, v_s, g_swa = jnp.split(proj, IN_SPLITS, axis=-1)

    q = (rms_norm(c_q, q_a_g) @ w_q_up).reshape(B, S, MLA_HEADS, MLA_QK_DIM)
    q_nope = q[..., :MLA_NOPE_DIM]
    q_rope = apply_rope(q[..., MLA_NOPE_DIM:], cos_mla, sin_mla)
    k_rope = apply_rope(k_rope, cos_mla, sin_mla)
    kv = (rms_norm(c_kv, kv_a_g) @ w_kv_up).reshape(B, S, MLA_HEADS, MLA_NOPE_DIM + MLA_V_DIM)
    k_nope = kv[..., :MLA_NOPE_DIM]
    v_mla = kv[..., MLA_NOPE_DIM:]
    o_mla = mla_attention(q_nope, q_rope, k_nope, k_rope, v_mla)

    q_s = apply_rope(q_s.reshape(B, S, SWA_Q_HEADS, SWA_HEAD_DIM), cos_swa, sin_swa)
    k_s = apply_rope(k_s.reshape(B, S, SWA_KV_HEADS, SWA_HEAD_DIM), cos_swa, sin_swa)
    v_s = v_s.reshape(B, S, SWA_KV_HEADS, SWA_HEAD_DIM)
    o_swa = sliding_window_sink_attention(q_s, k_s, v_s, sinks)

    mixed = jnp.concatenate([o_mla * jax.nn.silu(g_mla), o_swa * jax.nn.silu(g_swa)], axis=-1)
    return x + mixed @ w_out


def setup_inputs(seed: int = 0) -> dict:
    key = jax.random.key(seed)
    ks = jax.random.split(key, 11)
    f32 = jnp.float32

    def w(k, shape, fan_in):
        return jax.random.normal(k, shape, f32) * (fan_in ** -0.5)

    def gain(k, shape):
        return 1.0 + 0.02 * jax.random.normal(k, shape, f32)

    return {
        "x": jax.random.normal(ks[0], (BATCH, SEQ, D_MODEL), f32),
        "ln_mix": gain(ks[1], (DEPTH, D_MODEL)),
        "w_in": w(ks[2], (DEPTH, D_MODEL, IN_WIDTH), D_MODEL),
        "q_a_norm": gain(ks[3], (DEPTH, MLA_Q_RANK)),
        "w_q_up": w(ks[4], (DEPTH, MLA_Q_RANK, MLA_HEADS * MLA_QK_DIM), MLA_Q_RANK),
        "kv_a_norm": gain(ks[5], (DEPTH, MLA_KV_RANK)),
        "w_kv_up": w(ks[6], (DEPTH, MLA_KV_RANK, MLA_HEADS * (MLA_NOPE_DIM + MLA_V_DIM)), MLA_KV_RANK),
        "attn_sinks": jax.random.normal(ks[7], (DEPTH, SWA_Q_HEADS), f32),
        "w_out": w(ks[8], (DEPTH, MIX_WIDTH, D_MODEL), MIX_WIDTH),
        "final_norm": gain(ks[9], (D_MODEL,)),
    }


def reference(x, ln_mix, w_in, q_a_norm, w_q_up, kv_a_norm, w_kv_up, attn_sinks, w_out, final_norm):
    S = x.shape[1]
    cos_mla, sin_mla = rope_tables(S, MLA_ROPE_DIM)
    cos_swa, sin_swa = rope_tables(S, SWA_HEAD_DIM)
    h = x
    for l in range(DEPTH):
        h = hybrid_layer(h, ln_mix[l], w_in[l], q_a_norm[l], w_q_up[l], kv_a_norm[l],
                         w_kv_up[l], attn_sinks[l], w_out[l],
                         cos_mla, sin_mla, cos_swa, sin_swa)
    return rms_norm(h, final_norm)
```

```cpp
#include <hip/hip_runtime.h>
#include <cstdio>
#include <cstdint>
#include <cmath>

namespace nv {
constexpr int B = 8, S = 2048, DM = 1024, M = B * S;
constexpr int INW = 2240;
constexpr int O_CQ = 0, O_CKV = 256, O_KR = 384, O_GM = 448, O_QS = 960, O_KS = 1472, O_VS = 1600, O_GS = 1728;
constexpr float EPS = 1e-6f;

__global__ void rmsnorm_k(const float* x, int ldx, const float* g, float* out, int ldo, int W) {
    const int row = blockIdx.x; const float* xr = x + (size_t)row * ldx; float* o = out + (size_t)row * ldo;
    __shared__ float red[256];
    float s = 0.f;
    for (int c = threadIdx.x; c < W; c += 256) { float v = xr[c]; s += v * v; }
    red[threadIdx.x] = s; __syncthreads();
    for (int o2 = 128; o2 > 0; o2 >>= 1) { if (threadIdx.x < o2) red[threadIdx.x] += red[threadIdx.x + o2]; __syncthreads(); }
    const float rs = 1.0f / sqrtf(red[0] / (float)W + EPS);
    for (int c = threadIdx.x; c < W; c += 256) o[c] = xr[c] * rs * g[c];
}

__global__ void gemm_k(const float* A, int lda, const float* Bm, int ldb, float* C, int ldc, int K) {
    __shared__ float As[16][65]; __shared__ float Bs[16][65];
    const int tx = threadIdx.x & 15, ty = threadIdx.x >> 4; const int m0 = blockIdx.y * 64, n0 = blockIdx.x * 64;
    float acc[4][4] = {};
    for (int k0 = 0; k0 < K; k0 += 16) {
        for (int i = threadIdx.x; i < 64 * 16; i += 256) { int r = i >> 4, c = i & 15; As[c][r] = A[(size_t)(m0 + r) * lda + k0 + c]; }
        for (int i = threadIdx.x; i < 16 * 64; i += 256) { int r = i >> 6, c = i & 63; Bs[r][c] = Bm[(size_t)(k0 + r) * ldb + n0 + c]; }
        __syncthreads();
#pragma unroll
        for (int k = 0; k < 16; ++k) {
            float a[4], b[4];
#pragma unroll
            for (int i = 0; i < 4; ++i) { a[i] = As[k][ty * 4 + i]; b[i] = Bs[k][tx * 4 + i]; }
#pragma unroll
            for (int i = 0; i < 4; ++i)
#pragma unroll
                for (int j = 0; j < 4; ++j) acc[i][j] += a[i] * b[j];
        }
        __syncthreads();
    }
    for (int i = 0; i < 4; ++i) for (int j = 0; j < 4; ++j) C[(size_t)(m0 + ty * 4 + i) * ldc + n0 + tx * 4 + j] = acc[i][j];
}

__global__ void rope_tab_k(float2* cs) {
    const int idx = blockIdx.x * 256 + threadIdx.x; if (idx >= S * 32) return;
    const int s = idx >> 5, i = idx & 31;
    const float inv = (float)(1.0 / pow(10000.0, (double)(2 * i) / 64.0));
    const float ang = (float)s * inv;
    cs[idx] = make_float2((float)cos((double)ang), (float)sin((double)ang));
}
__global__ void rope_k(float* x, int ld, int off, int nvec, const float2* cs) {
    const int row = blockIdx.x; const int s = row % S;
    for (int t = threadIdx.x; t < nvec * 32; t += blockDim.x) {
        const int v = t >> 5, i = t & 31; float* p = x + (size_t)row * ld + off + v * 64;
        const float2 c = cs[s * 32 + i]; const float x1 = p[i], x2 = p[i + 32];
        p[i] = x1 * c.x - x2 * c.y; p[i + 32] = x2 * c.x + x1 * c.y;
    }
}
__global__ void mla_attn_k(const float* q, const float* kv, const float* proj, float* o_mla) {
    const int m = blockIdx.x, h = blockIdx.y; const int b = m / S, s = m % S;
    __shared__ float qs[192]; __shared__ float sc[S]; __shared__ float red[256];
    for (int d = threadIdx.x; d < 192; d += 256) qs[d] = q[(size_t)m * 768 + h * 192 + d];
    __syncthreads();
    const float scale = 1.0f / sqrtf(192.0f);
    float mx = -1e30f;
    for (int k = threadIdx.x; k <= s; k += 256) {
        const size_t mk = (size_t)b * S + k; const float* kn = kv + mk * 1024 + h * 256; const float* kr = proj + mk * INW + O_KR;
        float a = 0.f;
#pragma unroll 8
        for (int d = 0; d < 128; ++d) a += qs[d] * kn[d];
#pragma unroll 8
        for (int d = 0; d < 64; ++d) a += qs[128 + d] * kr[d];
        a *= scale; sc[k] = a; mx = fmaxf(mx, a);
    }
    red[threadIdx.x] = mx; __syncthreads();
    for (int o2 = 128; o2 > 0; o2 >>= 1) { if (threadIdx.x < o2) red[threadIdx.x] = fmaxf(red[threadIdx.x], red[threadIdx.x + o2]); __syncthreads(); }
    mx = red[0]; __syncthreads();
    float sum = 0.f;
    for (int k = threadIdx.x; k <= s; k += 256) { const float p = expf(sc[k] - mx); sc[k] = p; sum += p; }
    red[threadIdx.x] = sum; __syncthreads();
    for (int o2 = 128; o2 > 0; o2 >>= 1) { if (threadIdx.x < o2) red[threadIdx.x] += red[threadIdx.x + o2]; __syncthreads(); }
    sum = red[0];
    if (threadIdx.x < 128) {
        const int d = threadIdx.x; float a = 0.f;
#pragma unroll 4
        for (int k = 0; k <= s; ++k) a += sc[k] * kv[((size_t)b * S + k) * 1024 + h * 256 + 128 + d];
        o_mla[(size_t)m * 512 + h * 128 + d] = a / sum;
    }
}
__global__ void swa_attn_k(const float* proj, const float* sinks, float* o_swa) {
    const int m = blockIdx.x, hq = blockIdx.y; const int b = m / S, s = m % S; const int hkv = hq / 4;
    __shared__ float qs[64]; __shared__ float sc[128]; __shared__ float red[128];
    if (threadIdx.x < 64) qs[threadIdx.x] = proj[(size_t)m * INW + O_QS + hq * 64 + threadIdx.x];
    __syncthreads();
    const int k = s - 127 + threadIdx.x; float a = -1e30f;
    if (k >= 0) { const float* kp = proj + ((size_t)b * S + k) * INW + O_KS + hkv * 64; float t = 0.f; for (int d = 0; d < 64; ++d) t += qs[d] * kp[d]; a = t * 0.125f; }
    const float sk = sinks[hq];
    red[threadIdx.x] = a; __syncthreads();
    for (int o2 = 64; o2 > 0; o2 >>= 1) { if (threadIdx.x < o2) red[threadIdx.x] = fmaxf(red[threadIdx.x], red[threadIdx.x + o2]); __syncthreads(); }
    const float mx = fmaxf(red[0], sk); __syncthreads();
    const float p = (k >= 0) ? expf(a - mx) : 0.f; sc[threadIdx.x] = p; red[threadIdx.x] = p; __syncthreads();
    for (int o2 = 64; o2 > 0; o2 >>= 1) { if (threadIdx.x < o2) red[threadIdx.x] += red[threadIdx.x + o2]; __syncthreads(); }
    const float sum = red[0] + expf(sk - mx);
    if (threadIdx.x < 64) {
        const int d = threadIdx.x; float acc = 0.f;
        for (int j = 0; j < 128; ++j) { const int kk = s - 127 + j; if (kk >= 0) acc += sc[j] * proj[((size_t)b * S + kk) * INW + O_VS + hkv * 64 + d]; }
        o_swa[(size_t)m * 512 + hq * 64 + d] = acc / sum;
    }
}
__global__ void gate_k(const float* o_mla, const float* o_swa, const float* proj, float* mixed) {
    const int m = blockIdx.x;
    for (int c = threadIdx.x; c < 1024; c += 256) {
        float o, g;
        if (c < 512) { o = o_mla[(size_t)m * 512 + c]; g = proj[(size_t)m * INW + O_GM + c]; }
        else { o = o_swa[(size_t)m * 512 + c - 512]; g = proj[(size_t)m * INW + O_GS + c - 512]; }
        mixed[(size_t)m * 1024 + c] = o * (g / (1.0f + expf(-g)));
    }
}
__global__ void add_k(const float* x, float* y, size_t n) { size_t i = (size_t)blockIdx.x * 256 + threadIdx.x; if (i < n) y[i] += x[i]; }
}

extern "C" void kernel_launch(void* const* d_in, const int* in_sizes, int n_in, void* d_out, int out_size, void* d_ws, size_t ws_size, hipStream_t stream) {
    using namespace nv;
    const float* x = (const float*)d_in[0]; const float* ln = (const float*)d_in[1]; const float* w_in = (const float*)d_in[2];
    const float* qg = (const float*)d_in[3]; const float* wq = (const float*)d_in[4]; const float* kvg = (const float*)d_in[5];
    const float* wkv = (const float*)d_in[6]; const float* sinks = (const float*)d_in[7]; const float* wo = (const float*)d_in[8]; const float* fg = (const float*)d_in[9];
    float* out = (float*)d_out;
    char* ws = (char*)d_ws;
    float* proj = (float*)ws;
    float* q = (float*)(ws + (size_t)M * INW * 4);
    float* kv = (float*)(ws + (size_t)M * INW * 4 + (size_t)M * 768 * 4);
    float2* cs = (float2*)(ws + (size_t)M * INW * 4 + (size_t)M * 768 * 4 + (size_t)M * 1024 * 4);
    float* h = out;
    float* cqn = out; float* ckvn = out + (size_t)M * 256;
    float* o_mla = out; float* o_swa = out + (size_t)M * 512;
    float* mixed = kv;
    rmsnorm_k<<<M, 256, 0, stream>>>(x, DM, ln, h, DM, DM);
    gemm_k<<<dim3(INW / 64, M / 64), 256, 0, stream>>>(h, DM, w_in, INW, proj, INW, DM);
    rope_tab_k<<<S * 32 / 256, 256, 0, stream>>>(cs);
    rmsnorm_k<<<M, 256, 0, stream>>>(proj + O_CQ, INW, qg, cqn, 256, 256);
    rmsnorm_k<<<M, 256, 0, stream>>>(proj + O_CKV, INW, kvg, ckvn, 128, 128);
    gemm_k<<<dim3(768 / 64, M / 64), 256, 0, stream>>>(cqn, 256, wq, 768, q, 768, 256);
    gemm_k<<<dim3(1024 / 64, M / 64), 256, 0, stream>>>(ckvn, 128, wkv, 1024, kv, 1024, 128);
    for (int hh = 0; hh < 4; ++hh) rope_k<<<M, 64, 0, stream>>>(q, 768, hh * 192 + 128, 1, cs);
    rope_k<<<M, 64, 0, stream>>>(proj, INW, O_KR, 1, cs);
    rope_k<<<M, 256, 0, stream>>>(proj, INW, O_QS, 8, cs);
    rope_k<<<M, 64, 0, stream>>>(proj, INW, O_KS, 2, cs);
    mla_attn_k<<<dim3(M, 4), 256, 0, stream>>>(q, kv, proj, o_mla);
    swa_attn_k<<<dim3(M, 8), 128, 0, stream>>>(proj, sinks, o_swa);
    gate_k<<<M, 256, 0, stream>>>(o_mla, o_swa, proj, mixed);
    gemm_k<<<dim3(DM / 64, M / 64), 256, 0, stream>>>(mixed, DM, wo, DM, h, DM, DM);
    add_k<<<(unsigned)(((size_t)M * DM + 255) / 256), 256, 0, stream>>>(x, h, (size_t)M * DM);
    rmsnorm_k<<<M, 256, 0, stream>>>(h, DM, fg, out, DM, DM);
}
```
